# Optimizing an MI355X kernel written in HIP

```python
import math
import jax, jax.numpy as jnp
from jax import lax
import numpy as np

D_MODEL = 1024
BATCH = 8
SEQ = 4096
DEPTH = 2

A_WIDTH = D_MODEL // 2
B_WIDTH = D_MODEL // 2
A_CONV = 3
B_CONV = 31
EVEN_IN = 3 * A_WIDTH + 2 * B_WIDTH

C_HEAD_DIM = 64
C_WIDTH = D_MODEL // 2
C_HEADS = C_WIDTH // (2 * C_HEAD_DIM)
C_QK = C_HEADS * 2 * C_HEAD_DIM
Q_BLOCK = 128
D_WIDTH = D_MODEL // 2
CHUNK = 128
D_GROUP_DIM = 128
D_GROUPS = D_WIDTH // D_GROUP_DIM
ODD_IN = 3 * C_QK + 2 * D_WIDTH

D_FF = -(-8 * D_MODEL // (3 * 256)) * 256

N_EVEN = (DEPTH + 1) // 2
N_ODD = DEPTH // 2
DEEPNORM_ALPHA = (2 * DEPTH) ** 0.25
DEEPNORM_BETA = (8 * DEPTH) ** -0.25
LN_EPS = 1e-5

kernel_name = "hybrid_shortconv_conformer_diffattn_gmlp"


def layer_norm(x, g, b):
    xf = x.astype(jnp.float32)
    mu = jnp.mean(xf, axis=-1, keepdims=True)
    xc = xf - mu
    var = jnp.mean(xc * xc, axis=-1, keepdims=True)
    y = xc * lax.rsqrt(var + LN_EPS) * g.astype(jnp.float32) + b.astype(jnp.float32)
    return y.astype(x.dtype)


def rms_norm(x, g):
    xf = x.astype(jnp.float32)
    y = xf * lax.rsqrt(jnp.mean(xf * xf, axis=-1, keepdims=True) + LN_EPS) * g.astype(jnp.float32)
    return y.astype(x.dtype)


def causal_depthwise_conv(x, w):
    k_width, ch = w.shape
    return lax.conv_general_dilated(
        x, w[:, None, :].astype(x.dtype), window_strides=(1,),
        padding=[(k_width - 1, 0)], dimension_numbers=("NWC", "WIO", "NWC"),
        feature_group_count=ch)


def shortconv_conformer_mixer(x, w_in, conv_a_w, conv_b_w, conv_b_bias, conv_ln_g, conv_ln_b, w_out):
    proj = x @ w_in.astype(x.dtype)
    gate_b, gate_c, h, glu_a, glu_g = jnp.split(
        proj, [A_WIDTH, 2 * A_WIDTH, 3 * A_WIDTH, 3 * A_WIDTH + B_WIDTH], axis=-1)
    y_a = gate_b * causal_depthwise_conv(gate_c * h, conv_a_w)
    z = glu_a * jax.nn.sigmoid(glu_g)
    z = causal_depthwise_conv(z, conv_b_w) + conv_b_bias.astype(x.dtype)
    y_b = jax.nn.silu(layer_norm(z, conv_ln_g, conv_ln_b))
    return jnp.concatenate([y_a, y_b], axis=-1) @ w_out.astype(x.dtype)


def diffattn_gmlp_mixer(x, w_in, lambda_q1, lambda_k1, lambda_q2, lambda_k2, subln_g,
                        gmlp_ln_g, gmlp_ln_b, spatial_w, spatial_b, w_out, lambda_init):
    bsz, seq, _ = x.shape
    proj = x @ w_in.astype(x.dtype)
    q, k, v, uv = jnp.split(proj, [C_QK, 2 * C_QK, 3 * C_QK], axis=-1)
    q = q.reshape(bsz, seq, C_HEADS, 2, C_HEAD_DIM)
    k = k.reshape(bsz, seq, C_HEADS, 2, C_HEAD_DIM)
    v = v.reshape(bsz, seq, C_HEADS, 2 * C_HEAD_DIM)

    lam = (jnp.exp(jnp.sum(lambda_q1.astype(jnp.float32) * lambda_k1.astype(jnp.float32)))
           - jnp.exp(jnp.sum(lambda_q2.astype(jnp.float32) * lambda_k2.astype(jnp.float32)))
           + lambda_init)
    scale = C_HEAD_DIM ** -0.5
    n_blocks = seq // Q_BLOCK
    q_blocks = q.reshape(bsz, n_blocks, Q_BLOCK, C_HEADS, 2, C_HEAD_DIM).transpose(1, 0, 2, 3, 4, 5)
    key_pos = jnp.arange(seq)

    def attend(args):
        q_blk, blk = args
        s = jnp.einsum("bqhcd,bkhcd->bhcqk", q_blk, k).astype(jnp.float32) * scale
        q_pos = blk * Q_BLOCK + jnp.arange(Q_BLOCK)
        mask = key_pos[None, :] <= q_pos[:, None]
        s = jnp.where(mask, s, -jnp.inf)
        p = jax.nn.softmax(s, axis=-1)
        a = p[:, :, 0] - lam * p[:, :, 1]
        return jnp.einsum("bhqk,bkhe->bqhe", a.astype(v.dtype), v)

    o = lax.map(attend, (q_blocks, jnp.arange(n_blocks)))
    o = o.transpose(1, 0, 2, 3, 4).reshape(bsz, seq, C_HEADS, 2 * C_HEAD_DIM)
    o = rms_norm(o, subln_g) * (1.0 - lambda_init)
    y_c = o.reshape(bsz, seq, C_WIDTH)

    z = jax.nn.gelu(uv)
    u, vg = jnp.split(z, 2, axis=-1)
    vg = vg.reshape(bsz, seq // CHUNK, CHUNK, D_GROUPS, D_GROUP_DIM)
    vg = layer_norm(vg, gmlp_ln_g, gmlp_ln_b)
    tri = jnp.tril(jnp.ones((CHUNK, CHUNK), dtype=bool))
    w_causal = jnp.where(tri[None], spatial_w, 0.0).astype(x.dtype)
    sp = jnp.einsum("gts,bcsgd->bctgd", w_causal, vg) + spatial_b.T.astype(x.dtype)[:, :, None]
    y_d = u * sp.reshape(bsz, seq, D_WIDTH)

    return jnp.concatenate([y_c, y_d], axis=-1) @ w_out.astype(x.dtype)


def swiglu(x, w_gate, w_up, w_down):
    return (jax.nn.silu(x @ w_gate.astype(x.dtype)) * (x @ w_up.astype(x.dtype))) @ w_down.astype(x.dtype)


def setup_inputs(seed: int = 0) -> dict:
    key = jax.random.key(seed)
    ks = jax.random.split(key, 26)
    f32 = jnp.float32
    nrm = lambda k, shape, s: jax.random.normal(k, shape, f32) * s
    mix_w = 2 * D_MODEL // 2
    return {
        "x": nrm(ks[0], (BATCH, SEQ, D_MODEL), 1.0),
        "even_w_in": nrm(ks[1], (N_EVEN, D_MODEL, EVEN_IN), D_MODEL ** -0.5),
        "even_conv_a_w": nrm(ks[2], (N_EVEN, A_CONV, A_WIDTH), A_CONV ** -0.5),
        "even_conv_b_w": nrm(ks[3], (N_EVEN, B_CONV, B_WIDTH), B_CONV ** -0.5),
        "even_conv_b_bias": nrm(ks[4], (N_EVEN, B_WIDTH), 0.01),
        "even_conv_ln_g": 1.0 + nrm(ks[5], (N_EVEN, B_WIDTH), 0.05),
        "even_conv_ln_b": nrm(ks[6], (N_EVEN, B_WIDTH), 0.01),
        "even_w_out": nrm(ks[7], (N_EVEN, mix_w, D_MODEL), mix_w ** -0.5 * DEEPNORM_BETA),
        "odd_w_in": nrm(ks[8], (N_ODD, D_MODEL, ODD_IN), D_MODEL ** -0.5),
        "odd_lambda_q1": nrm(ks[9], (N_ODD, C_HEAD_DIM), 0.1),
        "odd_lambda_k1": nrm(ks[10], (N_ODD, C_HEAD_DIM), 0.1),
        "odd_lambda_q2": nrm(ks[11], (N_ODD, C_HEAD_DIM), 0.1),
        "odd_lambda_k2": nrm(ks[12], (N_ODD, C_HEAD_DIM), 0.1),
        "odd_subln_g": 1.0 + nrm(ks[13], (N_ODD, 2 * C_HEAD_DIM), 0.05),
        "odd_gmlp_ln_g": 1.0 + nrm(ks[14], (N_ODD, D_GROUPS, D_GROUP_DIM), 0.05),
        "odd_gmlp_ln_b": nrm(ks[15], (N_ODD, D_GROUPS, D_GROUP_DIM), 0.01),
        "odd_spatial_w": nrm(ks[16], (N_ODD, D_GROUPS, CHUNK, CHUNK), CHUNK ** -0.5),
        "odd_spatial_b": 1.0 + nrm(ks[17], (N_ODD, D_GROUPS, CHUNK), 0.05),
        "odd_w_out": nrm(ks[18], (N_ODD, mix_w, D_MODEL), mix_w ** -0.5 * DEEPNORM_BETA),
        "mix_ln_g": 1.0 + nrm(ks[19], (DEPTH, D_MODEL), 0.05),
        "mix_ln_b": nrm(ks[20], (DEPTH, D_MODEL), 0.01),
        "ffn_w_gate": nrm(ks[21], (DEPTH, D_MODEL, D_FF), D_MODEL ** -0.5),
        "ffn_w_up": nrm(ks[22], (DEPTH, D_MODEL, D_FF), D_MODEL ** -0.5),
        "ffn_w_down": nrm(ks[23], (DEPTH, D_FF, D_MODEL), D_FF ** -0.5 * DEEPNORM_BETA),
        "ffn_ln_g": 1.0 + nrm(ks[24], (DEPTH, D_MODEL), 0.05),
        "ffn_ln_b": nrm(ks[25], (DEPTH, D_MODEL), 0.01),
    }


def reference(x, even_w_in, even_conv_a_w, even_conv_b_w, even_conv_b_bias, even_conv_ln_g,
              even_conv_ln_b, even_w_out, odd_w_in, odd_lambda_q1, odd_lambda_k1, odd_lambda_q2,
              odd_lambda_k2, odd_subln_g, odd_gmlp_ln_g, odd_gmlp_ln_b, odd_spatial_w, odd_spatial_b,
              odd_w_out, mix_ln_g, mix_ln_b, ffn_w_gate, ffn_w_up, ffn_w_down, ffn_ln_g, ffn_ln_b):
    for layer in range(DEPTH):
        j = layer // 2
        if layer % 2 == 0:
            m = shortconv_conformer_mixer(x, even_w_in[j], even_conv_a_w[j], even_conv_b_w[j],
                                          even_conv_b_bias[j], even_conv_ln_g[j], even_conv_ln_b[j],
                                          even_w_out[j])
        else:
            lambda_init = 0.8 - 0.6 * math.exp(-0.3 * layer)
            m = diffattn_gmlp_mixer(x, odd_w_in[j], odd_lambda_q1[j], odd_lambda_k1[j],
                                    odd_lambda_q2[j], odd_lambda_k2[j], odd_subln_g[j],
                                    odd_gmlp_ln_g[j], odd_gmlp_ln_b[j], odd_spatial_w[j],
                                    odd_spatial_b[j], odd_w_out[j], lambda_init)
        x = layer_norm(DEEPNORM_ALPHA * x + m, mix_ln_g[layer], mix_ln_b[layer])
        f = swiglu(x, ffn_w_gate[layer], ffn_w_up[layer], ffn_w_down[layer])
        x = layer_norm(DEEPNORM_ALPHA * x + f, ffn_ln_g[layer], ffn_ln_b[layer])
    return x
```

```cpp
#include <hip/hip_runtime.h>
#include <cstdio>
#include <cstdint>

namespace nv {
constexpr int M = 32768, D = 1024, SEQ = 4096, FF = 2816, NIN = 2560;
constexpr float ALPHA = 1.4142135623730951f, EPS = 1e-5f;
constexpr float LAMBDA_INIT = 0.35550906759f;

__device__ __forceinline__ float sigmoidf_(float x) { return 1.f / (1.f + __expf(-x)); }
__device__ __forceinline__ float gelu_tanh(float x) { return 0.5f * x * (1.f + tanhf(0.7978845608028654f * (x + 0.044715f * x * x * x))); }

__device__ __forceinline__ float block_sum(float v, float* red) {
    for (int o = 32; o > 0; o >>= 1) v += __shfl_xor(v, o);
    const int w = threadIdx.x >> 6, l = threadIdx.x & 63, nw = blockDim.x >> 6;
    __syncthreads(); if (l == 0) red[w] = v; __syncthreads();
    float s = 0.f; for (int i = 0; i < nw; ++i) s += red[i];
    return s;
}
__device__ __forceinline__ float block_max(float v, float* red) {
    for (int o = 32; o > 0; o >>= 1) v = fmaxf(v, __shfl_xor(v, o));
    const int w = threadIdx.x >> 6, l = threadIdx.x & 63, nw = blockDim.x >> 6;
    __syncthreads(); if (l == 0) red[w] = v; __syncthreads();
    float s = red[0]; for (int i = 1; i < nw; ++i) s = fmaxf(s, red[i]);
    return s;
}

template <int MODE>
__global__ void __launch_bounds__(256) sgemm(const float* __restrict__ A, const float* __restrict__ B, const float* __restrict__ B2, float* __restrict__ C, int Mm, int N, int K) {
    __shared__ float As[8][128];
    __shared__ float Bs[8][128];
    __shared__ float Bs2[MODE == 1 ? 8 : 1][128];
    const int tid = threadIdx.x, tx = tid & 15, ty = tid >> 4;
    const int row0 = blockIdx.y * 128, col0 = blockIdx.x * 128;
    float acc[8][8]; float acc2[MODE == 1 ? 8 : 1][8];
#pragma unroll
    for (int i = 0; i < 8; ++i)
#pragma unroll
        for (int j = 0; j < 8; ++j) { acc[i][j] = 0.f; if constexpr (MODE == 1) acc2[i][j] = 0.f; }
    const int ar = tid >> 1, ak = (tid & 1) * 4;
    const int bk = tid >> 5, bc = (tid & 31) * 4;
    for (int k0 = 0; k0 < K; k0 += 8) {
        const float4 av = *(const float4*)(A + (size_t)(row0 + ar) * K + k0 + ak);
        const float4 bv = *(const float4*)(B + (size_t)(k0 + bk) * N + col0 + bc);
        float4 bv2 = bv; if (MODE == 1) bv2 = *(const float4*)(B2 + (size_t)(k0 + bk) * N + col0 + bc);
        __syncthreads();
        As[ak + 0][ar] = av.x; As[ak + 1][ar] = av.y; As[ak + 2][ar] = av.z; As[ak + 3][ar] = av.w;
        *(float4*)&Bs[bk][bc] = bv;
        if (MODE == 1) *(float4*)&Bs2[bk][bc] = bv2;
        __syncthreads();
#pragma unroll
        for (int kk = 0; kk < 8; ++kk) {
            float a[8], b[8], b2[8];
            const float4 a0 = *(const float4*)&As[kk][ty * 4], a1 = *(const float4*)&As[kk][64 + ty * 4];
            const float4 b0 = *(const float4*)&Bs[kk][tx * 4], b1 = *(const float4*)&Bs[kk][64 + tx * 4];
            a[0] = a0.x; a[1] = a0.y; a[2] = a0.z; a[3] = a0.w; a[4] = a1.x; a[5] = a1.y; a[6] = a1.z; a[7] = a1.w;
            b[0] = b0.x; b[1] = b0.y; b[2] = b0.z; b[3] = b0.w; b[4] = b1.x; b[5] = b1.y; b[6] = b1.z; b[7] = b1.w;
            if constexpr (MODE == 1) {
                const float4 c0 = *(const float4*)&Bs2[kk][tx * 4], c1 = *(const float4*)&Bs2[kk][64 + tx * 4];
                b2[0] = c0.x; b2[1] = c0.y; b2[2] = c0.z; b2[3] = c0.w; b2[4] = c1.x; b2[5] = c1.y; b2[6] = c1.z; b2[7] = c1.w;
            }
#pragma unroll
            for (int i = 0; i < 8; ++i)
#pragma unroll
                for (int j = 0; j < 8; ++j) { acc[i][j] = fmaf(a[i], b[j], acc[i][j]); if constexpr (MODE == 1) acc2[i][j] = fmaf(a[i], b2[j], acc2[i][j]); }
        }
    }
#pragma unroll
    for (int i = 0; i < 8; ++i) {
        const int r = row0 + (i < 4 ? ty * 4 + i : 64 + ty * 4 + (i - 4));
#pragma unroll
        for (int jh = 0; jh < 2; ++jh) {
            float4 o;
            float v[4];
#pragma unroll
            for (int j = 0; j < 4; ++j) { const float g = acc[i][jh * 4 + j]; v[j] = (MODE == 1) ? g * sigmoidf_(g) * acc2[i][jh * 4 + j] : g; }
            o.x = v[0]; o.y = v[1]; o.z = v[2]; o.w = v[3];
            *(float4*)(C + (size_t)r * N + col0 + jh * 64 + tx * 4) = o;
        }
    }
}

__global__ void __launch_bounds__(512) even_mix(const float* __restrict__ proj, const float* __restrict__ wA, const float* __restrict__ wB, const float* __restrict__ bias,
                                                const float* __restrict__ lg, const float* __restrict__ lb, float* __restrict__ Y) {
    __shared__ float red[16];
    const int t = blockIdx.x, tt = t % SEQ, c = threadIdx.x;
    const float* P = proj + (size_t)t * NIN;
    float ua = 0.f;
#pragma unroll
    for (int k = 0; k < 3; ++k) { const int tp = tt - 2 + k; if (tp >= 0) { const float* Pk = proj + (size_t)(t - 2 + k) * NIN; ua += wA[k * 512 + c] * (Pk[512 + c] * Pk[1024 + c]); } }
    const float ya = P[c] * ua;
    float zc = bias[c];
    for (int k = 0; k < 31; ++k) { const int tp = tt - 30 + k; if (tp >= 0) { const float* Pk = proj + (size_t)(t - 30 + k) * NIN; zc += wB[k * 512 + c] * (Pk[1536 + c] * sigmoidf_(Pk[2048 + c])); } }
    const float mean = block_sum(zc, red) * (1.f / 512.f);
    const float d = zc - mean;
    const float var = block_sum(d * d, red) * (1.f / 512.f);
    const float yn = d * rsqrtf(var + EPS) * lg[c] + lb[c];
    Y[(size_t)t * D + c] = ya;
    Y[(size_t)t * D + 512 + c] = yn * sigmoidf_(yn);
}

__global__ void __launch_bounds__(256) add_ln(const float* X, const float* __restrict__ Mx, const float* __restrict__ g, const float* __restrict__ b, float* out) {
    __shared__ float red[16];
    const size_t row = blockIdx.x; const int c = threadIdx.x * 4;
    const float4 xv = *(const float4*)(X + row * D + c), mv = *(const float4*)(Mx + row * D + c);
    float v[4] = {ALPHA * xv.x + mv.x, ALPHA * xv.y + mv.y, ALPHA * xv.z + mv.z, ALPHA * xv.w + mv.w};
    const float mean = block_sum(v[0] + v[1] + v[2] + v[3], red) * (1.f / D);
    float q = 0.f;
#pragma unroll
    for (int i = 0; i < 4; ++i) { v[i] -= mean; q += v[i] * v[i]; }
    const float rstd = rsqrtf(block_sum(q, red) * (1.f / D) + EPS);
    const float4 gv = *(const float4*)(g + c), bv = *(const float4*)(b + c);
    float4 o; o.x = v[0] * rstd * gv.x + bv.x; o.y = v[1] * rstd * gv.y + bv.y; o.z = v[2] * rstd * gv.z + bv.z; o.w = v[3] * rstd * gv.w + bv.w;
    *(float4*)(out + row * D + c) = o;
}

__global__ void lam_kernel(const float* q1, const float* k1, const float* q2, const float* k2, float* lam) {
    const int l = threadIdx.x;
    float a = q1[l] * k1[l], b = q2[l] * k2[l];
    for (int o = 32; o > 0; o >>= 1) { a += __shfl_xor(a, o); b += __shfl_xor(b, o); }
    if (l == 0) lam[0] = expf(a) - expf(b) + LAMBDA_INIT;
}

__global__ void __launch_bounds__(256) odd_attn(const float* __restrict__ proj, const float* __restrict__ lamp, const float* __restrict__ subg, float* __restrict__ Y) {
    __shared__ float qs[128];
    __shared__ float sc0[SEQ];
    __shared__ float sc1[SEQ];
    __shared__ float red[16];
    __shared__ float osum[128];
    const int t = blockIdx.x, h = blockIdx.y, tid = threadIdx.x;
    const int b = t / SEQ, tq = t % SEQ, nk = tq + 1;
    const float lam = lamp[0];
    if (tid < 128) qs[tid] = proj[(size_t)t * NIN + h * 128 + tid] * 0.125f;
    __syncthreads();
    float m0 = -INFINITY, m1 = -INFINITY;
    for (int j = tid; j < nk; j += 256) {
        const float* kp = proj + (size_t)(b * SEQ + j) * NIN + 512 + h * 128;
        float s0 = 0.f, s1 = 0.f;
        for (int d = 0; d < 64; d += 4) {
            const float4 k0 = *(const float4*)(kp + d), k1 = *(const float4*)(kp + 64 + d);
            s0 += qs[d] * k0.x + qs[d + 1] * k0.y + qs[d + 2] * k0.z + qs[d + 3] * k0.w;
            s1 += qs[64 + d] * k1.x + qs[65 + d] * k1.y + qs[66 + d] * k1.z + qs[67 + d] * k1.w;
        }
        sc0[j] = s0; sc1[j] = s1; m0 = fmaxf(m0, s0); m1 = fmaxf(m1, s1);
    }
    m0 = block_max(m0, red); m1 = block_max(m1, red);
    float l0 = 0.f, l1 = 0.f;
    for (int j = tid; j < nk; j += 256) { const float e0 = __expf(sc0[j] - m0), e1 = __expf(sc1[j] - m1); sc0[j] = e0; sc1[j] = e1; l0 += e0; l1 += e1; }
    l0 = block_sum(l0, red); l1 = block_sum(l1, red);
    const float i0 = 1.f / l0, i1 = lam / l1;
    for (int j = tid; j < nk; j += 256) sc0[j] = sc0[j] * i0 - sc1[j] * i1;
    __syncthreads();
    const int e = tid & 127, half = tid >> 7;
    float acc = 0.f;
    const float* vp = proj + (size_t)(b * SEQ) * NIN + 1024 + h * 128 + e;
    for (int j = half; j < nk; j += 2) acc += sc0[j] * vp[(size_t)j * NIN];
    if (half == 1) osum[e] = acc;
    __syncthreads();
    float o = 0.f;
    if (half == 0) o = acc + osum[e];
    const float ms = block_sum(half == 0 ? o * o : 0.f, red) * (1.f / 128.f);
    if (half == 0) Y[(size_t)t * D + h * 128 + e] = o * rsqrtf(ms + EPS) * subg[e] * (1.f - LAMBDA_INIT);
}

__global__ void __launch_bounds__(256) gmlp_pre(float* proj, const float* __restrict__ lg, const float* __restrict__ lb) {
    const int t = blockIdx.x, tid = threadIdx.x, g = tid >> 6, lane = tid & 63;
    float* P = proj + (size_t)t * NIN;
    P[1536 + tid] = gelu_tanh(P[1536 + tid]); P[1536 + 256 + tid] = gelu_tanh(P[1536 + 256 + tid]);
    float* V = P + 2048 + g * 128;
    float v0 = gelu_tanh(V[lane * 2]), v1 = gelu_tanh(V[lane * 2 + 1]);
    float s = v0 + v1;
    for (int o = 32; o > 0; o >>= 1) s += __shfl_xor(s, o);
    const float mean = s * (1.f / 128.f);
    v0 -= mean; v1 -= mean;
    float q = v0 * v0 + v1 * v1;
    for (int o = 32; o > 0; o >>= 1) q += __shfl_xor(q, o);
    const float rstd = rsqrtf(q * (1.f / 128.f) + EPS);
    V[lane * 2] = v0 * rstd * lg[g * 128 + lane * 2] + lb[g * 128 + lane * 2];
    V[lane * 2 + 1] = v1 * rstd * lg[g * 128 + lane * 2 + 1] + lb[g * 128 + lane * 2 + 1];
}
__global__ void __launch_bounds__(128) gmlp_sp(const float* __restrict__ proj, const float* __restrict__ W, const float* __restrict__ sb, float* __restrict__ Y) {
    const int t = blockIdx.x, g = blockIdx.y, d = threadIdx.x, tt = t & 127, base = t - tt;
    const float* w = W + (size_t)g * 16384 + tt * 128;
    float acc = 0.f;
    for (int s = 0; s <= tt; ++s) acc += w[s] * proj[(size_t)(base + s) * NIN + 2048 + g * 128 + d];
    Y[(size_t)t * D + 512 + g * 128 + d] = proj[(size_t)t * NIN + 1536 + g * 128 + d] * (acc + sb[g * 128 + tt]);
}
}

extern "C" void kernel_launch(void* const* d_in, const int* in_sizes, int n_in, void* d_out, int out_size, void* d_ws, size_t ws_size, hipStream_t stream) {
    using namespace nv;
    const float* x = (const float*)d_in[0];
    const float* F[26]; for (int i = 0; i < 26; ++i) F[i] = (const float*)d_in[i];
    float* out = (float*)d_out;
    float* bufA = (float*)d_ws;
    float* Y = bufA + (size_t)M * FF;
    float* lam = Y + (size_t)M * D;
    const dim3 blk(256);
    auto gemm0 = [&](const float* A, const float* B, float* C, int N, int K) { sgemm<0><<<dim3(N / 128, M / 128), blk, 0, stream>>>(A, B, nullptr, C, M, N, K); };
    auto gemm1 = [&](const float* A, const float* B, const float* B2, float* C, int N, int K) { sgemm<1><<<dim3(N / 128, M / 128), blk, 0, stream>>>(A, B, B2, C, M, N, K); };
    gemm0(x, F[1], bufA, NIN, D);
    even_mix<<<M, 512, 0, stream>>>(bufA, F[2], F[3], F[4], F[5], F[6], Y);
    gemm0(Y, F[7], bufA, D, D);
    add_ln<<<M, 256, 0, stream>>>(x, bufA, F[19], F[20], out);
    gemm1(out, F[21], F[22], bufA, FF, D);
    gemm0(bufA, F[23], Y, D, FF);
    add_ln<<<M, 256, 0, stream>>>(out, Y, F[24], F[25], out);
    gemm0(out, F[8], bufA, NIN, D);
    lam_kernel<<<1, 64, 0, stream>>>(F[9], F[10], F[11], F[12], lam);
    odd_attn<<<dim3(M, 4), 256, 0, stream>>>(bufA, lam, F[13], Y);
    gmlp_pre<<<M, 256, 0, stream>>>(bufA, F[14], F[15]);
    gmlp_sp<<<dim3(M, 4), 128, 0, stream>>>(bufA, F[16], F[17], Y);
    gemm0(Y, F[18], bufA, D, D);
    add_ln<<<M, 256, 0, stream>>>(out, bufA, F[19] + D, F[20] + D, out);
    gemm1(out, F[21] + (size_t)D * FF, F[22] + (size_t)D * FF, bufA, FF, D);
    gemm0(bufA, F[23] + (size_t)FF * D, Y, D, FF);
    add_ln<<<M, 256, 0, stream>>>(out, Y, F[24] + D, F[25] + D, out);
}
```
